# Optimizing an MI355X kernel written in HIP

```python
import math
import jax, jax.numpy as jnp
from jax import lax
import numpy as np

D_MODEL = 1024
BATCH = 4
SEQ = 8192
DEPTH = 4

N_HEADS = 4
BRANCH_W = D_MODEL // 2
N_BRANCH = 3
GLA_DK = D_MODEL // 16
GLA_DV = BRANCH_W // N_HEADS
GLA_RANK = 16
GLA_TAU = 16.0
GLA_CHUNK = 64
RET_DK = D_MODEL // 16
RET_DV = BRANCH_W // N_HEADS
RET_CHUNK = 128
RET_ROPE_BASE = 10000.0
DIL_HD = BRANCH_W // N_HEADS
DIL_GROUPS = ((128, 1), (512, 4), (2048, 16))
N_DIL = len(DIL_GROUPS)
ROPE_THETA = 500000.0
ROPE_DIMS = DIL_HD // 4
D_FF = -(-8 * D_MODEL // (3 * 256)) * 256
ALPHA = (2 * DEPTH) ** 0.25
BETA = (8 * DEPTH) ** -0.25

IN_WIDTHS = (N_HEADS * GLA_DK, N_HEADS * GLA_DK, BRANCH_W, BRANCH_W, GLA_RANK,
             N_HEADS * RET_DK, N_HEADS * RET_DK, BRANCH_W, BRANCH_W,
             N_DIL * BRANCH_W, N_DIL * BRANCH_W, N_DIL * BRANCH_W,
             N_BRANCH * D_MODEL)
D_IN = sum(IN_WIDTHS)
IN_SPLITS = tuple(int(s) for s in np.cumsum(IN_WIDTHS)[:-1])

kernel_name = 'hybrid_gated_gla_retention_dilated_attn'

F32 = jnp.float32


def _layer_norm(x, g, b, eps=1e-5):
    xf = x.astype(F32)
    mu = jnp.mean(xf, axis=-1, keepdims=True)
    var = jnp.mean(jnp.square(xf - mu), axis=-1, keepdims=True)
    return ((xf - mu) * lax.rsqrt(var + eps) * g.astype(F32) + b.astype(F32)).astype(x.dtype)


def _head_rms_norm(o, g, eps=1e-6):
    B, S, H, D = o.shape
    y = o * lax.rsqrt(jnp.mean(jnp.square(o), axis=-1, keepdims=True) + eps)
    return (y * g.astype(F32).reshape(H, D)).reshape(B, S, H * D)


def _head_group_norm(o, g, eps=1e-5):
    B, S, H, D = o.shape
    mu = jnp.mean(o, axis=-1, keepdims=True)
    var = jnp.mean(jnp.square(o - mu), axis=-1, keepdims=True)
    y = (o - mu) * lax.rsqrt(var + eps)
    return (y * g.astype(F32).reshape(H, D)).reshape(B, S, H * D)


def _rotary(x, pos, n_rot, base):
    half = n_rot // 2
    inv = base ** (-jnp.arange(half, dtype=F32) * 2.0 / n_rot)
    ang = pos[:, None] * inv[None, :]
    cos = jnp.cos(ang)[None, :, None, :]
    sin = jnp.sin(ang)[None, :, None, :]
    xf = x.astype(F32)
    x1 = xf[..., :half]
    x2 = xf[..., half:n_rot]
    return jnp.concatenate([x1 * cos - x2 * sin, x2 * cos + x1 * sin, xf[..., n_rot:]], axis=-1)


def _gla_chunked(q, k, v, log_a):
    B, S, H, DK = q.shape
    DV = v.shape[-1]
    C = GLA_CHUNK
    N = S // C
    q = q.astype(F32).reshape(B, N, C, H, DK) * (DK ** -0.5)
    k = k.astype(F32).reshape(B, N, C, H, DK)
    v = v.astype(F32).reshape(B, N, C, H, DV)
    b = jnp.cumsum(log_a.astype(F32).reshape(B, N, C, H, DK), axis=2)
    b_last = b[:, :, -1:]
    q_s = q * jnp.exp(b)
    k_s = k * jnp.exp(-b)
    causal = jnp.tril(jnp.ones((C, C), dtype=bool))
    att = jnp.where(causal, jnp.einsum('bnihd,bnjhd->bnhij', q_s, k_s), 0.0)
    o_intra = jnp.einsum('bnhij,bnjhe->bnihe', att, v)
    kv = jnp.einsum('bnjhd,bnjhe->bnhde', k * jnp.exp(b_last - b), v)
    decay = jnp.exp(b_last[:, :, 0])

    def step(state, inp):
        dec, kv_n = inp
        return dec[..., None] * state + kv_n, state

    s0 = jnp.zeros((B, H, DK, DV), F32)
    _, s_prev = lax.scan(step, s0, (jnp.moveaxis(decay, 1, 0), jnp.moveaxis(kv, 1, 0)))
    s_prev = jnp.moveaxis(s_prev, 0, 1)
    o_inter = jnp.einsum('bnihd,bnhde->bnihe', q_s, s_prev)
    return (o_intra + o_inter).reshape(B, S, H, DV)


def _retention_chunked(q, k, v):
    B, S, H, DK = q.shape
    DV = v.shape[-1]
    C = RET_CHUNK
    N = S // C
    log_g = jnp.log1p(-jnp.exp2(-5.0 - jnp.arange(H, dtype=F32)))
    q = q.astype(F32).reshape(B, N, C, H, DK)
    k = k.astype(F32).reshape(B, N, C, H, DK) * (DK ** -0.5)
    v = v.astype(F32).reshape(B, N, C, H, DV)
    idx = jnp.arange(C, dtype=F32)
    diff = idx[:, None] - idx[None, :]
    dmat = jnp.where(diff >= 0, jnp.exp(jnp.maximum(diff, 0.0)[None] * log_g[:, None, None]), 0.0)
    att = jnp.einsum('bnihd,bnjhd->bnhij', q, k) * dmat
    o_intra = jnp.einsum('bnhij,bnjhe->bnihe', att, v)
    q_dec = q * jnp.exp((idx + 1.0)[:, None] * log_g[None, :])[:, :, None]
    k_dec = k * jnp.exp((C - 1.0 - idx)[:, None] * log_g[None, :])[:, :, None]
    kv = jnp.einsum('bnjhd,bnjhe->bnhde', k_dec, v)
    chunk_decay = jnp.exp(C * log_g)[:, None, None]

    def step(state, kv_n):
        return chunk_decay * state + kv_n, state

    s0 = jnp.zeros((B, H, DK, DV), F32)
    _, s_prev = lax.scan(step, s0, jnp.moveaxis(kv, 1, 0))
    s_prev = jnp.moveaxis(s_prev, 0, 1)
    o_inter = jnp.einsum('bnihd,bnhde->bnihe', q_dec, s_prev)
    return (o_intra + o_inter).reshape(B, S, H, DV)


def _dilated_window_attention(q, k, v, window, dilation):
    B, S, H, D = q.shape
    span = window // dilation
    n = S // dilation
    nb = -(-n // span)
    n_pad = nb * span

    def strided(t):
        t = t.astype(F32).reshape(B, n, dilation, H, D)
        return jnp.pad(t, ((0, 0), (0, n_pad - n), (0, 0), (0, 0), (0, 0)))

    def band(t):
        tp = jnp.pad(t, ((0, 0), (span, 0), (0, 0), (0, 0), (0, 0))).reshape(B, nb + 1, span, dilation, H, D)
        return jnp.concatenate([tp[:, :-1], tp[:, 1:]], axis=2)

    qb = strided(q).reshape(B, nb, span, dilation, H, D)
    kb = band(strided(k))
    vb = band(strided(v))
    s = jnp.einsum('bnichd,bnjchd->bnchij', qb, kb) * (D ** -0.5)
    i = jnp.arange(span)[:, None]
    j = jnp.arange(2 * span)[None, :]
    dist = i + span - j
    key_idx = jnp.arange(nb)[:, None, None] * span + j[None] - span
    mask = (dist >= 0)[None] & (dist <= span)[None] & (key_idx >= 0)
    s = jnp.where(mask[None, :, None, None], s, -jnp.inf)
    m = jnp.max(s, axis=-1)
    p = jnp.exp(s - m[..., None])
    den = jnp.sum(p, axis=-1)
    o = jnp.einsum('bnchij,bnjchd->bnichd', p, vb) / jnp.moveaxis(den, -1, 2)[..., None]
    lse = jnp.moveaxis(m + jnp.log(den), -1, 2)
    o = o.reshape(B, n_pad, dilation, H, D)[:, :n].reshape(B, S, H, D)
    lse = lse.reshape(B, n_pad, dilation, H)[:, :n].reshape(B, S, H)
    return o, lse


def _mixer(x, w_in, w_gla_a2, b_gla_a, gla_norm_g, ret_norm_g, w_branch, b_gate, w_out):
    B, S, _ = x.shape
    pos = jnp.arange(S, dtype=F32)
    proj = x @ w_in
    (gq, gk, gv, gr, ga, rq, rk, rv, rg, dq, dk, dv, gate) = jnp.split(proj, IN_SPLITS, axis=-1)

    log_a = jax.nn.log_sigmoid((ga @ w_gla_a2 + b_gla_a).astype(F32)) / GLA_TAU
    o_a = _gla_chunked(gq.reshape(B, S, N_HEADS, GLA_DK), gk.reshape(B, S, N_HEADS, GLA_DK),
                       gv.reshape(B, S, N_HEADS, GLA_DV), log_a.reshape(B, S, N_HEADS, GLA_DK))
    o_a = _head_rms_norm(o_a, gla_norm_g) * jax.nn.silu(gr.astype(F32))

    q_r = _rotary(rq.reshape(B, S, N_HEADS, RET_DK), pos, RET_DK, RET_ROPE_BASE)
    k_r = _rotary(rk.reshape(B, S, N_HEADS, RET_DK), pos, RET_DK, RET_ROPE_BASE)
    o_b = _retention_chunked(q_r, k_r, rv.reshape(B, S, N_HEADS, RET_DV))
    o_b = _head_group_norm(o_b, ret_norm_g) * jax.nn.silu(rg.astype(F32))

    dq = dq.reshape(B, S, N_DIL, N_HEADS, DIL_HD)
    dk = dk.reshape(B, S, N_DIL, N_HEADS, DIL_HD)
    dv = dv.reshape(B, S, N_DIL, N_HEADS, DIL_HD)
    outs = []
    lses = []
    for g, (window, dilation) in enumerate(DIL_GROUPS):
        qg = _rotary(dq[:, :, g], pos, ROPE_DIMS, ROPE_THETA)
        kg = _rotary(dk[:, :, g], pos, ROPE_DIMS, ROPE_THETA)
        o_g, lse_g = _dilated_window_attention(qg, kg, dv[:, :, g], window, dilation)
        outs.append(o_g)
        lses.append(lse_g)
    wts = jax.nn.softmax(jnp.stack(lses, axis=0), axis=0)
    o_c = jnp.sum(wts[..., None] * jnp.stack(outs, axis=0), axis=0).reshape(B, S, BRANCH_W)

    y_a = o_a.astype(x.dtype) @ w_branch[0]
    y_b = o_b.astype(x.dtype) @ w_branch[1]
    y_c = o_c.astype(x.dtype) @ w_branch[2]
    gates = jax.nn.sigmoid((gate + b_gate).astype(F32)).reshape(B, S, N_BRANCH, D_MODEL).astype(x.dtype)
    merged = gates[:, :, 0] * y_a + gates[:, :, 1] * y_b + gates[:, :, 2] * y_c
    return merged @ w_out


def _swiglu(x, w_gate, w_up, w_down):
    return (jax.nn.silu(x @ w_gate) * (x @ w_up)) @ w_down


def setup_inputs(seed: int = 0) -> dict:
    key = jax.random.key(seed)
    ks = jax.random.split(key, 16)
    nrm = jax.random.normal
    return {
        'x': nrm(ks[0], (BATCH, SEQ, D_MODEL), F32),
        'w_in': nrm(ks[1], (DEPTH, D_MODEL, D_IN), F32) * D_MODEL ** -0.5,
        'w_gla_a2': nrm(ks[2], (DEPTH, GLA_RANK, N_HEADS * GLA_DK), F32) * GLA_RANK ** -0.5,
        'b_gla_a': 0.1 * nrm(ks[3], (DEPTH, N_HEADS * GLA_DK), F32),
        'gla_norm_g': 1.0 + 0.02 * nrm(ks[4], (DEPTH, BRANCH_W), F32),
        'ret_norm_g': 1.0 + 0.02 * nrm(ks[5], (DEPTH, BRANCH_W), F32),
        'w_branch': nrm(ks[6], (DEPTH, N_BRANCH, BRANCH_W, D_MODEL), F32) * BRANCH_W ** -0.5,
        'b_gate': 0.02 * nrm(ks[7], (DEPTH, N_BRANCH * D_MODEL), F32),
        'w_out': nrm(ks[8], (DEPTH, D_MODEL, D_MODEL), F32) * (D_MODEL ** -0.5 * BETA),
        'ln1_g': 1.0 + 0.02 * nrm(ks[9], (DEPTH, D_MODEL), F32),
        'ln1_b': 0.02 * nrm(ks[10], (DEPTH, D_MODEL), F32),
        'w_ffn_gate': nrm(ks[11], (DEPTH, D_MODEL, D_FF), F32) * D_MODEL ** -0.5,
        'w_ffn_up': nrm(ks[12], (DEPTH, D_MODEL, D_FF), F32) * D_MODEL ** -0.5,
        'w_ffn_down': nrm(ks[13], (DEPTH, D_FF, D_MODEL), F32) * (D_FF ** -0.5 * BETA),
        'ln2_g': 1.0 + 0.02 * nrm(ks[14], (DEPTH, D_MODEL), F32),
        'ln2_b': 0.02 * nrm(ks[15], (DEPTH, D_MODEL), F32),
    }


def reference(x, w_in, w_gla_a2, b_gla_a, gla_norm_g, ret_norm_g, w_branch, b_gate, w_out,
              ln1_g, ln1_b, w_ffn_gate, w_ffn_up, w_ffn_down, ln2_g, ln2_b):
    for l in range(DEPTH):
        h = _mixer(x, w_in[l], w_gla_a2[l], b_gla_a[l], gla_norm_g[l], ret_norm_g[l],
                   w_branch[l], b_gate[l], w_out[l])
        x = _layer_norm(ALPHA * x + h, ln1_g[l], ln1_b[l])
        f = _swiglu(x, w_ffn_gate[l], w_ffn_up[l], w_ffn_down[l])
        x = _layer_norm(ALPHA * x + f, ln2_g[l], ln2_b[l])
    return x
```

```cpp
#include <hip/hip_runtime.h>
#include <hip/hip_cooperative_groups.h>
#include <cstdio>
#include <cstdint>
#include <cmath>
namespace cg = cooperative_groups;

#define LAS __attribute__((address_space(3)))
typedef unsigned short bf16_t;
typedef short bf16x8 __attribute__((ext_vector_type(8)));
typedef float f32x4 __attribute__((ext_vector_type(4)));
typedef float f32x2 __attribute__((ext_vector_type(2)));
typedef unsigned u32x4 __attribute__((ext_vector_type(4)));
typedef unsigned u32x2 __attribute__((ext_vector_type(2)));

constexpr int T_TOK = 32768, SEQ = 8192, DM = 1024, DFF = 2816, NLAYER = 4, DIN = 10768;
constexpr int LD1 = 3072, LD2 = 4608, LDG = 3072, LDO = 1536;
constexpr int WIN_ROWS = 11008;
constexpr float ALPHA_DN = 1.681792830507429f;

constexpr size_t MiB = 1u << 20;
constexpr size_t WS_CTL = 0, CTL_ZERO_BYTES = 1 * MiB;
constexpr size_t WS_RC = 1 * MiB, WS_RS = 2 * MiB;
constexpr size_t WS_DC = 3 * MiB, WS_DS = 3 * MiB + 512 * 1024;
constexpr size_t WS_WIN = 4 * MiB;
constexpr size_t WS_WB = 26 * MiB;
constexpr size_t WS_WOUT = 29 * MiB;
constexpr size_t WS_WGU = 31 * MiB;
constexpr size_t WS_WD = 42 * MiB;
constexpr size_t WS_XB = 52 * MiB;
constexpr size_t WS_O = 116 * MiB;
constexpr size_t WS_GA = 212 * MiB;
constexpr size_t WS_LSE = 214 * MiB;
constexpr size_t WS_KV = 216 * MiB;
constexpr size_t WS_DEC = 280 * MiB;
constexpr size_t WS_PROJ = 281 * MiB;
constexpr size_t WS_MERGED = WS_PROJ + 192 * MiB;
constexpr size_t WS_ALT = 569 * MiB;
constexpr size_t WS_END = 665 * MiB;

constexpr int LDS_BYTES = 147456, LDSCTL_OFF = 131072, MISC_OFF = LDSCTL_OFF + 320;

struct Params {
    const float* in[16];
    float* out; unsigned char* ws;
};
typedef const __attribute__((address_space(4))) Params* PP;
__device__ __forceinline__ PP get_pp() { PP p = (PP)__builtin_amdgcn_kernarg_segment_ptr(); asm volatile("" : "+s"(p)); return p; }
__device__ const float INVF[48] = {1.0f, 0.749894202f, 0.562341332f, 0.421696514f, 0.316227764f, 0.237137377f, 0.177827939f, 0.133352146f, 0.100000001f, 0.0749894232f, 0.0562341325f, 0.0421696492f, 0.0316227749f, 0.0237137377f, 0.0177827943f, 0.013335214f, 0.00999999978f, 0.00749894232f, 0.00562341325f, 0.00421696482f, 0.00316227763f, 0.00237137382f, 0.00177827943f, 0.00133352145f, 0.00100000005f, 0.000749894185f, 0.000562341302f, 0.000421696517f, 0.000316227757f, 0.00023713737f, 0.00017782794f, 0.00013335215f,
    1.0f, 0.440366596f, 0.193922743f, 0.0853971019f, 0.0376060307f, 0.0165604409f, 0.00729266461f, 0.00321144611f, 0.00141421356f, 0.000622772437f, 0.000274248188f, 0.000120769735f, 5.31829573e-05f, 2.34199997e-05f, 1.03133852e-05f, 4.54167048e-06f};

__device__ __forceinline__ unsigned f2bf(float f) { unsigned u = __builtin_bit_cast(unsigned, f); return (u + 0x7fffu + ((u >> 16) & 1u)) >> 16; }
__device__ __forceinline__ unsigned pk2(float lo, float hi) { return f2bf(lo) | (f2bf(hi) << 16); }
__device__ __forceinline__ float bflo(unsigned w) { return __builtin_bit_cast(float, w << 16); }
__device__ __forceinline__ float bfhi(unsigned w) { return __builtin_bit_cast(float, w & 0xffff0000u); }
__device__ __forceinline__ float sigmoidf_(float x) { return __builtin_amdgcn_rcpf(1.f + __expf(-x)); }
__device__ __forceinline__ float siluf_(float x) { return x * sigmoidf_(x); }
#define MFMA16(a, b, c) __builtin_amdgcn_mfma_f32_16x16x32_bf16((a), (b), (c), 0, 0, 0)

namespace pg8 {
constexpr int BM = 256, BK = 64, HALF = 128, HTB = HALF * BK * 2, STAGE_BYTES = 8 * HTB, NXCD = 8, WGM = 8;
__host__ __device__ __forceinline__ int lds_byte(int r, int c) { const int st = (r >> 4) * 2 + (c >> 5), rr = r & 15, cc = c & 31, ob = rr * 64 + cc * 2; return st * 1024 + (ob ^ (((ob >> 9) & 1) << 5)); }
__host__ __device__ __forceinline__ void stage_rc(int b, int& R, int& C) { const int st = b / 1024, sb = b % 1024, swz = sb ^ (((sb >> 9) & 1) << 5); R = (st >> 1) * 16 + swz / 64; C = (st & 1) * 32 + (swz % 64) / 2; }
__host__ __device__ __forceinline__ int perm32(int rho) { const int n = rho >> 4, i = rho & 15; return 8 * (i >> 2) + 4 * n + (i & 3); }

struct Unit { int pm, pn, z; };
struct Gemm { const bf16_t* A; const bf16_t* Bt; int lda, ldb, K; long zA, zB; };

struct Order {
    int nM, nN, nwg, G, c, nz;
    __device__ void init(int M, int N, int G_, int c_, int nz_) { nM = M / BM; nN = N / BM; nwg = nM * nN; G = G_; c = c_; nz = nz_; }
    __device__ bool next(int i, Unit& u) const {
        const int ii = i / nz; u.z = i - ii * nz;
        const long L = (long)ii * G + c; if (L >= nwg) return false;
        int wgid = (int)L; { const int q = nwg / NXCD, r = nwg % NXCD, xcd = wgid % NXCD, off = wgid / NXCD; wgid = (xcd < r ? xcd * (q + 1) : r * (q + 1) + (xcd - r) * q) + off; }
        const int nig = WGM * nN, gid = wgid / nig, fm = gid * WGM, gsz = (nM - fm) < WGM ? (nM - fm) : WGM;
        u.pm = fm + ((wgid % nig) % gsz); u.pn = (wgid % nig) / gsz; return true;
    }
};

typedef __bf16 bf16x2_t __attribute__((ext_vector_type(2)));
__device__ __forceinline__ unsigned cvt_pk_bf16(float lo, float hi) { f32x2 v = {lo, hi}; bf16x2_t b = __builtin_convertvector(v, bf16x2_t); return __builtin_bit_cast(unsigned, b); }

template <int MODE> struct EpiBf16 {
    static constexpr bool PERM = true;
    bf16_t* O; int ldc; const float* bias; float* GA; int gapn;
    __device__ __forceinline__ void operator()(const f32x4 (&acc)[2][2][4][2], const Unit& u, int wr, int wc, int fr, int fq) const {
        asm volatile("" : "+v"(fr), "+v"(fq));
        const int row0 = u.pm * BM + wr * 64 + fr; const int col0 = u.pn * BM + wc * 32 + 8 * fq;
        if (MODE == 1 && u.pn == gapn) {
            if (wc == 0 && fq < 2) {
#pragma unroll
                for (int ai = 0; ai < 2; ++ai)
#pragma unroll
                    for (int m = 0; m < 4; ++m) { float* g = GA + (size_t)(row0 + ai * HALF + m * 16) * 16 + 8 * fq; *(f32x4*)g = acc[ai][0][m][0]; *(f32x4*)(g + 4) = acc[ai][0][m][1]; }
            }
            return;
        }
        f32x4 bv[2][2];
#pragma unroll
        for (int bj = 0; bj < 2; ++bj)
#pragma unroll
            for (int n = 0; n < 2; ++n) bv[bj][n] = (MODE == 2) ? *(const f32x4*)(bias + col0 + bj * HALF + 4 * n) : (f32x4){0.f, 0.f, 0.f, 0.f};
#pragma unroll
        for (int ai = 0; ai < 2; ++ai)
#pragma unroll
            for (int m = 0; m < 4; ++m) { bf16_t* rowp = O + (size_t)(row0 + ai * HALF + m * 16) * ldc + col0;
#pragma unroll
                for (int bj = 0; bj < 2; ++bj) { f32x4 v0 = acc[ai][bj][m][0], v1 = acc[ai][bj][m][1];
                    if (MODE == 2) { v0 = v0 + bv[bj][0]; v1 = v1 + bv[bj][1];
#pragma unroll
                        for (int j = 0; j < 4; ++j) { v0[j] = sigmoidf_(v0[j]); v1[j] = sigmoidf_(v1[j]); } }
                    u32x4 w; w.x = cvt_pk_bf16(v0[0], v0[1]); w.y = cvt_pk_bf16(v0[2], v0[3]); w.z = cvt_pk_bf16(v1[0], v1[1]); w.w = cvt_pk_bf16(v1[2], v1[3]);
                    *(u32x4*)(rowp + bj * HALF) = w; } }
    }
};
struct EpiSwiglu {
    static constexpr bool PERM = true;
    bf16_t* H;
    __device__ __forceinline__ void operator()(const f32x4 (&acc)[2][2][4][2], const Unit& u, int wr, int wc, int fr, int fq) const {
        asm volatile("" : "+v"(fr), "+v"(fq));
        const int row0 = u.pm * BM + wr * 64 + fr; const int col0 = u.pn * HALF + wc * 32 + 8 * fq;
#pragma unroll
        for (int ai = 0; ai < 2; ++ai)
#pragma unroll
            for (int m = 0; m < 4; ++m) { bf16_t* rowp = H + (size_t)(row0 + ai * HALF + m * 16) * DFF + col0;
                f32x4 h0, h1;
#pragma unroll
                for (int j = 0; j < 4; ++j) { h0[j] = siluf_(acc[ai][0][m][0][j]) * acc[ai][1][m][0][j]; h1[j] = siluf_(acc[ai][0][m][1][j]) * acc[ai][1][m][1][j]; }
                u32x4 w; w.x = cvt_pk_bf16(h0[0], h0[1]); w.y = cvt_pk_bf16(h0[2], h0[3]); w.z = cvt_pk_bf16(h1[0], h1[1]); w.w = cvt_pk_bf16(h1[2], h1[3]);
                *(u32x4*)rowp = w; }
    }
};
struct EpiBranch {
    static constexpr bool PERM = true;
    const bf16_t* GATES; float* PS  ; bf16_t* MERGED;
    __device__ __forceinline__ void operator()(const f32x4 (&acc)[2][2][4][2], const Unit& u, int wr, int wc, int fr, int fq) const {
        asm volatile("" : "+v"(fr), "+v"(fq));
        const int row0 = u.pm * BM + wr * 64 + fr; const int col0 = u.pn * BM + wc * 32 + 8 * fq; int tid = threadIdx.x; asm volatile("" : "+v"(tid));
#pragma unroll
        for (int ai = 0; ai < 2; ++ai)
#pragma unroll
            for (int m = 0; m < 4; ++m) { const size_t row = (size_t)(row0 + ai * HALF + m * 16);
#pragma unroll
                for (int bj = 0; bj < 2; ++bj) {
                    const u32x4 gw = *(const u32x4*)(GATES + row * LDG + u.z * DM + col0 + bj * HALF);
                    f32x4 v0 = acc[ai][bj][m][0], v1 = acc[ai][bj][m][1];
                    v0[0] *= bflo(gw.x); v0[1] *= bfhi(gw.x); v0[2] *= bflo(gw.y); v0[3] *= bfhi(gw.y);
                    v1[0] *= bflo(gw.z); v1[1] *= bfhi(gw.z); v1[2] *= bflo(gw.w); v1[3] *= bfhi(gw.w);
                    f32x4* ps = (f32x4*)PS + (size_t)(((ai * 4 + m) * 2 + bj) * 2) * 512 + tid;
                    if (u.z > 0) { v0 = v0 + ps[0]; v1 = v1 + ps[512]; }
                    if (u.z < 2) { ps[0] = v0; ps[512] = v1; }
                    else { u32x4 w; w.x = cvt_pk_bf16(v0[0], v0[1]); w.y = cvt_pk_bf16(v0[2], v0[3]); w.z = cvt_pk_bf16(v1[0], v1[1]); w.w = cvt_pk_bf16(v1[2], v1[3]);
                        *(u32x4*)(MERGED + row * DM + col0 + bj * HALF) = w; } }
                asm volatile("" ::: "memory"); }
    }
};
struct EpiResid {
    static constexpr bool PERM = false;
    const float* Xin; float* Xout;
    __device__ __forceinline__ void operator()(const f32x4 (&acc)[2][2][4][2], const Unit& u, int wr, int wc, int fr, int fq) const {
        asm volatile("" : "+v"(fr), "+v"(fq));
        const int row0 = u.pm * BM + wr * 64 + fr; const int col0 = u.pn * BM + wc * 32 + 4 * fq;
#pragma unroll
        for (int ai = 0; ai < 2; ++ai)
#pragma unroll
            for (int m = 0; m < 4; ++m) { const size_t off = (size_t)(row0 + ai * HALF + m * 16) * DM + col0;
#pragma unroll
                for (int bj = 0; bj < 2; ++bj)
#pragma unroll
                    for (int n = 0; n < 2; ++n) { const size_t p = off + bj * HALF + n * 16; const f32x4 x = *(const f32x4*)(Xin + p); *(f32x4*)(Xout + p) = x * ALPHA_DN + acc[ai][bj][m][n]; } }
    }
};

template <class Epi>
__device__ __forceinline__ void gemm_phase(LAS unsigned char* lds, const Gemm g, const Order& S, const Epi& E) {
    int tid = threadIdx.x; asm volatile("" : "+v"(tid));
    const int wid = __builtin_amdgcn_readfirstlane(tid >> 6), lane = tid & 63, wr = wid >> 2, wc = wid & 3, fr = lane & 15, fq = lane >> 4;
    const int K = g.K, nt = K / BK;
    unsigned voffA[2], voffB[2];
#pragma unroll
    for (int i = 0; i < 2; ++i) { int R, C; stage_rc(tid * 16 + i * 8192, R, C); const int Rb = Epi::PERM ? ((R & ~31) + perm32(R & 31)) : R;
        voffA[i] = (unsigned)(R * g.lda + C) * 2u; voffB[i] = (unsigned)(Rb * g.ldb + C) * 2u; }
    const size_t kstep = (size_t)(BK * 2);
    const size_t hstepA = (size_t)HALF * g.lda * 2, hstepB = (size_t)HALF * g.ldb * 2;
    const size_t tstepA = 2 * hstepA, tstepB = 2 * hstepB;
    const unsigned ldsw = (unsigned)wid * 1024u;
    const int aoff = lds_byte(wr * 64 + fr, fq * 8), boff = lds_byte(wc * 32 + fr, fq * 8);
#define PG8_SA(b, h) (((b) * 2 + (h)) * HTB)
#define PG8_SB(b, h) ((4 + (b) * 2 + (h)) * HTB)
#define PG8_STAGE(bufoff, gbase, voff) do { _Pragma("unroll") for (int _i = 0; _i < 2; ++_i) \
        __builtin_amdgcn_global_load_lds((const unsigned*)((const char*)(gbase) + (voff)[_i]), (LAS unsigned*)(lds + (bufoff) + ldsw + _i * 8192), 16, 0, 0); } while (0)
#define PG8_LDA(dst, b, h) do { _Pragma("unroll") for (int m = 0; m < 4; ++m) _Pragma("unroll") for (int k = 0; k < 2; ++k) dst[m][k] = *(const LAS bf16x8*)(lds + PG8_SA(b, h) + aoff + m * 2048 + k * 1024); } while (0)
#define PG8_LDB(dst, b, h) do { _Pragma("unroll") for (int n = 0; n < 2; ++n) _Pragma("unroll") for (int k = 0; k < 2; ++k) dst[n][k] = *(const LAS bf16x8*)(lds + PG8_SB(b, h) + boff + n * 2048 + k * 1024); } while (0)
#define PG8_MMA(ai, bj, At, Bt) do { __builtin_amdgcn_s_setprio(1); _Pragma("unroll") for (int m = 0; m < 4; ++m) _Pragma("unroll") for (int n = 0; n < 2; ++n) _Pragma("unroll") for (int k = 0; k < 2; ++k) \
        acc[ai][bj][m][n] = __builtin_amdgcn_mfma_f32_16x16x32_bf16(Bt[n][k], At[m][k], acc[ai][bj][m][n], 0, 0, 0); __builtin_amdgcn_s_setprio(0); } while (0)
#define PG8_WAIT_V(n) asm volatile("s_waitcnt vmcnt(" #n ")" ::: "memory")
#define PG8_WAIT_L(n) asm volatile("s_waitcnt lgkmcnt(" #n ")" ::: "memory")
#define PG8_BAR __builtin_amdgcn_s_barrier()
#define PG8_SCHED __builtin_amdgcn_sched_barrier(0)
    Unit cur, nxt; int ui = 0;
    if (!S.next(0, cur)) return;
    f32x4 acc[2][2][4][2];
#pragma unroll
    for (int a = 0; a < 2; ++a)
#pragma unroll
        for (int b = 0; b < 2; ++b)
#pragma unroll
            for (int m = 0; m < 4; ++m)
#pragma unroll
                for (int n = 0; n < 2; ++n) acc[a][b][m][n] = (f32x4){0.f, 0.f, 0.f, 0.f};
    bf16x8 At[4][2], B0[2][2], B1[2][2];
    const char* cA = (const char*)g.A + (size_t)cur.z * g.zA * 2 + (size_t)cur.pm * tstepA; const char* cB = (const char*)g.Bt + (size_t)cur.z * g.zB * 2 + (size_t)cur.pn * tstepB;
    PG8_STAGE(PG8_SB(0, 0), cB, voffB); PG8_STAGE(PG8_SB(0, 1), cB + hstepB, voffB); PG8_STAGE(PG8_SA(0, 0), cA, voffA); PG8_STAGE(PG8_SA(0, 1), cA + hstepA, voffA);
    if (wr == 1) PG8_BAR;
    PG8_WAIT_V(2); PG8_BAR;
    PG8_STAGE(PG8_SB(1, 0), cB + kstep, voffB); PG8_STAGE(PG8_SA(1, 0), cA + kstep, voffA); PG8_STAGE(PG8_SB(1, 1), cB + hstepB + kstep, voffB);
    PG8_WAIT_V(6); PG8_BAR;
    for (;;) {
        const bool has_next = S.next(ui + 1, nxt);
        const char* nA = has_next ? (const char*)g.A + (size_t)nxt.z * g.zA * 2 + (size_t)nxt.pm * tstepA : cA;
        const char* nB = has_next ? (const char*)g.Bt + (size_t)nxt.z * g.zB * 2 + (size_t)nxt.pn * tstepB : cB;
        for (int t = 0; t < nt; t += 2) {
            const bool last = (t == nt - 2);
            const char* a1 = cA + (size_t)(t + 1) * kstep;
            const char* a2 = last ? nA : cA + (size_t)(t + 2) * kstep; const char* b2 = last ? nB : cB + (size_t)(t + 2) * kstep;
            const char* a3 = a2 + kstep; const char* b3 = b2 + kstep;
            PG8_LDB(B0, 0, 0); PG8_LDB(B1, 0, 1); PG8_SCHED; PG8_LDA(At, 0, 0); PG8_STAGE(PG8_SA(1, 1), a1 + hstepA, voffA);
            PG8_WAIT_V(8); PG8_WAIT_L(0); PG8_BAR; PG8_MMA(0, 0, At, B0); PG8_MMA(0, 1, At, B1); PG8_BAR; PG8_SCHED;
            PG8_LDA(At, 0, 1); PG8_STAGE(PG8_SB(0, 0), b2, voffB); PG8_STAGE(PG8_SB(0, 1), b2 + hstepB, voffB); PG8_STAGE(PG8_SA(0, 0), a2, voffA);
            PG8_WAIT_V(8); PG8_WAIT_L(0); PG8_BAR; PG8_MMA(1, 0, At, B0); PG8_MMA(1, 1, At, B1); PG8_BAR; PG8_SCHED;
            PG8_LDB(B0, 1, 0); PG8_LDB(B1, 1, 1); PG8_SCHED; PG8_LDA(At, 1, 0); PG8_STAGE(PG8_SA(0, 1), a2 + hstepA, voffA);
            PG8_WAIT_V(8); PG8_WAIT_L(0); PG8_BAR; PG8_MMA(0, 0, At, B0); PG8_MMA(0, 1, At, B1); PG8_BAR; PG8_SCHED;
            PG8_LDA(At, 1, 1); PG8_STAGE(PG8_SB(1, 0), b3, voffB); PG8_STAGE(PG8_SB(1, 1), b3 + hstepB, voffB); PG8_STAGE(PG8_SA(1, 0), a3, voffA);
            PG8_WAIT_V(8); PG8_WAIT_L(0); PG8_BAR; PG8_MMA(1, 0, At, B0); PG8_MMA(1, 1, At, B1); PG8_BAR; PG8_SCHED;
        }
        if (wr == 0) PG8_BAR;
        E(acc, cur, wr, wc, fr, fq);
        if (!has_next) break;
#pragma unroll
        for (int a = 0; a < 2; ++a)
#pragma unroll
            for (int b = 0; b < 2; ++b)
#pragma unroll
                for (int m = 0; m < 4; ++m)
#pragma unroll
                    for (int n = 0; n < 2; ++n) acc[a][b][m][n] = (f32x4){0.f, 0.f, 0.f, 0.f};
        cur = nxt; cA = nA; cB = nB; ++ui;
        if (wr == 1) PG8_BAR;
    }
    PG8_WAIT_V(0);
    PG8_BAR;
#undef PG8_SA
#undef PG8_SB
#undef PG8_STAGE
#undef PG8_LDA
#undef PG8_LDB
#undef PG8_MMA
#undef PG8_WAIT_V
#undef PG8_WAIT_L
#undef PG8_BAR
#undef PG8_SCHED
}
}

#define XB_TMO      128
#define XB_XCNT(j)  (256  + 64 * (j))
#define XB_XSUB(j)  (1280 + 64 * (j))
#define XB_XGEN(j)  (2304 + 64 * (j))
#define XB_TOP      3328
#define XB_TOPGEN   3392
#define XB_SPIN_CAP (1u << 22)
__device__ __forceinline__ unsigned xb_ld(unsigned* p)              { return __hip_atomic_load(p, __ATOMIC_RELAXED, __HIP_MEMORY_SCOPE_AGENT); }
__device__ __forceinline__ unsigned xb_add(unsigned* p, unsigned v) { return __hip_atomic_fetch_add(p, v, __ATOMIC_RELAXED, __HIP_MEMORY_SCOPE_AGENT); }
__device__ __forceinline__ unsigned xb_xcc_id() { return (unsigned)__builtin_amdgcn_s_getreg((3 << 11) | 20) & 0xFu; }
#define XB_SPIN(cond, bar) do { unsigned _sp = 0; while (cond) { __builtin_amdgcn_s_sleep(1); \
    if ((++_sp & 255u) == 0u) { if (xb_ld(&(bar)[XB_TMO])) break; if (_sp > XB_SPIN_CAP) { atomicAdd(&(bar)[XB_TMO], 1u); break; } } } } while (0)
struct XcdBarrier { unsigned* bar; unsigned x; volatile LAS unsigned* st; };
__device__ __forceinline__ XcdBarrier xcd_barrier_post(unsigned* bar, volatile LAS unsigned* st) {
    XcdBarrier b; b.bar = bar; b.x = xb_xcc_id(); b.st = st;
    if (threadIdx.x == 0) (void)xb_add(&bar[XB_XCNT(b.x)], 1u);
    return b;
}
__device__ __forceinline__ void xcd_barrier_complete(unsigned* bar, unsigned x, unsigned& nloc, unsigned& nx) {
    const unsigned G = gridDim.x * gridDim.y * gridDim.z;
    unsigned sum, cnt, mine, sp = 0u;
    for (;;) {
        sum = 0u; cnt = 0u; mine = 0u;
#pragma unroll
        for (unsigned j = 0; j < 16; ++j) { const unsigned c = xb_ld(&bar[XB_XCNT(j)]); sum += c; cnt += (c > 0u) ? 1u : 0u; mine = (j == x) ? c : mine; }
        if (sum == G) break;
        __builtin_amdgcn_s_sleep(1);
        if ((++sp & 255u) == 0u) { if (xb_ld(&bar[XB_TMO])) break; if (sp > XB_SPIN_CAP) { atomicAdd(&bar[XB_TMO], 1u); break; } }
    }
    nloc = mine > 0u ? mine : 1u; nx = cnt > 0u ? cnt : 1u;
}
__device__ __forceinline__ void xcd_barrier(const XcdBarrier& b) {
    asm volatile("s_waitcnt vmcnt(0)" ::: "memory");
    __syncthreads();
    if (threadIdx.x == 0) {
        unsigned* bar = b.bar;
        __builtin_amdgcn_s_waitcnt(0);
        unsigned nloc = b.st[0], nx = b.st[1];
        if (nloc == 0u) { xcd_barrier_complete(bar, b.x, nloc, nx); b.st[0] = nloc; b.st[1] = nx; }
        const unsigned old = xb_add(&bar[XB_XSUB(b.x)], 1u);
        const unsigned gen = old / nloc;
        if (old + 1u == (gen + 1u) * nloc) {
            __builtin_amdgcn_fence(__ATOMIC_RELEASE, "agent");
            asm volatile("s_waitcnt vmcnt(0)" ::: "memory");
            const unsigned og = xb_add(&bar[XB_TOP], 1u);
            const unsigned tg = og / nx;
            if (og + 1u == (tg + 1u) * nx) xb_add(&bar[XB_TOPGEN], 1u);
            else XB_SPIN(xb_ld(&bar[XB_TOPGEN]) == tg, bar);
            __builtin_amdgcn_fence(__ATOMIC_ACQUIRE, "agent");
            xb_add(&bar[XB_XGEN(b.x)], 1u);
            asm volatile("s_waitcnt vmcnt(0)" ::: "memory");
        } else {
            XB_SPIN(xb_ld(&bar[XB_XGEN(b.x)]) == gen, bar);
            __builtin_amdgcn_fence(__ATOMIC_ACQUIRE, "agent");
            asm volatile("s_waitcnt vmcnt(0)" ::: "memory");
        }
    }
    __syncthreads();
}

__device__ __forceinline__ float wave_sum(float v) {
#pragma unroll
    for (int o = 1; o < 64; o <<= 1) v += __shfl_xor(v, o);
    return v;
}

__device__ __forceinline__ void tr_item(const float* W, int ldsrc, int K, int k0, int scol, int nvalid, bf16_t* WTrow0, LAS float* scr, int lane) {
    const bool ok = (lane & 31) < nvalid;
#pragma unroll 8
    for (int i = 0; i < 32; ++i) { const int kk = 2 * i + (lane >> 5); scr[kk * 33 + (lane & 31)] = ok ? W[(size_t)(k0 + kk) * ldsrc + scol + (lane & 31)] : 0.f; }
    asm volatile("s_waitcnt lgkmcnt(0)" ::: "memory");
    const int c = lane & 7;
#pragma unroll
    for (int j = 0; j < 4; ++j) { const int n = (lane >> 3) + 8 * j; const LAS float* s = scr + (8 * c) * 33 + n;
        u32x4 o; o.x = pk2(s[0 * 33], s[1 * 33]); o.y = pk2(s[2 * 33], s[3 * 33]); o.z = pk2(s[4 * 33], s[5 * 33]); o.w = pk2(s[6 * 33], s[7 * 33]);
        *(u32x4*)(WTrow0 + (size_t)n * K + k0 + 8 * c) = o; }
    asm volatile("s_waitcnt lgkmcnt(0)" ::: "memory");
}

__device__ __forceinline__ void convert_weights(PP P, int l, LAS unsigned char* lds) {
    int tid = threadIdx.x; asm volatile("" : "+v"(tid));
    const int lane = tid & 63, wave = tid >> 6;
    LAS float* scr = (LAS float*)(lds + wave * 16384);
    const int gw = blockIdx.x * 8 + wave, NGW = gridDim.x * 8;
    unsigned char* ws = P->ws;
    constexpr int I_A = 16 * 344, I_B = 3 * 8 * 32, I_C = 16 * 32, I_D = 16 * 176, I_E = 44 * 32;
    for (int it = gw; it < I_A + I_B + I_C + I_D + I_E; it += NGW) {
        int r = it;
        if (r < I_A) { const int kb = r / 344, nb = r % 344, n0 = nb * 32; int scol, nvalid = 32;
            if (n0 < 1536) scol = n0; else if (n0 < 3072) scol = n0 + 16; else if (n0 < 3328) { scol = 1536; nvalid = (n0 == 3072) ? 16 : 0; }
            else if (n0 < 7936) scol = 3088 + (n0 - 3328); else scol = 7696 + (n0 - 7936);
            tr_item(P->in[1] + (size_t)l * DM * DIN, DIN, DM, kb * 64, scol, nvalid, (bf16_t*)(ws + WS_WIN) + (size_t)n0 * DM, scr, lane); continue; }
        r -= I_A;
        if (r < I_B) { const int br = r / 256, r2 = r % 256, kb = r2 / 32, nb = r2 % 32;
            tr_item(P->in[6] + (size_t)(l * 3 + br) * 512 * DM, DM, 512, kb * 64, nb * 32, 32, (bf16_t*)(ws + WS_WB) + (size_t)br * DM * 512 + (size_t)nb * 32 * 512, scr, lane); continue; }
        r -= I_B;
        if (r < I_C) { const int kb = r / 32, nb = r % 32;
            tr_item(P->in[8] + (size_t)l * DM * DM, DM, DM, kb * 64, nb * 32, 32, (bf16_t*)(ws + WS_WOUT) + (size_t)nb * 32 * DM, scr, lane); continue; }
        r -= I_C;
        if (r < I_D) { const int kb = r / 176, nb = r % 176, n0 = nb * 32, tile = n0 >> 8, within = n0 & 255, which = within >> 7, f0 = tile * 128 + (within & 127);
            tr_item((which ? P->in[12] : P->in[11]) + (size_t)l * DM * DFF, DFF, DM, kb * 64, f0, 32, (bf16_t*)(ws + WS_WGU) + (size_t)n0 * DM, scr, lane); continue; }
        r -= I_D;
        { const int kb = r / 32, nb = r % 32;
            tr_item(P->in[13] + (size_t)l * DFF * DM, DM, DFF, kb * 64, nb * 32, 32, (bf16_t*)(ws + WS_WD) + (size_t)nb * 32 * DFF, scr, lane); }
    }
}

__device__ __forceinline__ void prep0(PP P) {
    int tid = threadIdx.x; asm volatile("" : "+v"(tid));
    const size_t gt = (size_t)blockIdx.x * 512 + tid, NT = (size_t)gridDim.x * 512;
    const float* x = P->in[0]; bf16_t* XB = (bf16_t*)(P->ws + WS_XB);
    for (size_t i = gt; i < (size_t)T_TOK * DM / 8; i += NT) {
        const f32x4 a = *(const f32x4*)(x + i * 8), b = *(const f32x4*)(x + i * 8 + 4);
        u32x4 w; w.x = pk2(a[0], a[1]); w.y = pk2(a[2], a[3]); w.z = pk2(b[0], b[1]); w.w = pk2(b[2], b[3]);
        *(u32x4*)(XB + i * 8) = w;
    }
    float* RC = (float*)(P->ws + WS_RC); float* RS = (float*)(P->ws + WS_RS); float* DC = (float*)(P->ws + WS_DC); float* DS = (float*)(P->ws + WS_DS);
    for (size_t i = gt; i < (size_t)SEQ * 48; i += NT) {
        const int t = (int)(i / 48), f = (int)(i % 48);
        const float inv = INVF[f];
        const float ang = (float)t * inv;
        double r = (double)ang * 0.15915494309189535; r -= rint(r);
        const float fr = (float)r;
        const float sn = __builtin_amdgcn_sinf(fr), cs = __builtin_amdgcn_cosf(fr);
        if (f < 32) { RC[t * 32 + f] = cs; RS[t * 32 + f] = sn; } else { DC[t * 16 + f - 32] = cs; DS[t * 16 + f - 32] = sn; }
    }
}

__device__ __forceinline__ void ln_pass(float* X, bf16_t* XB, const float* g, const float* bt) {
    int tid = threadIdx.x; asm volatile("" : "+v"(tid));
    const int lane = tid & 63, wave = tid >> 6;
    const int gw = blockIdx.x * 8 + wave, NGW = gridDim.x * 8;
    f32x4 gg[4], bb[4];
#pragma unroll
    for (int j = 0; j < 4; ++j) { gg[j] = *(const f32x4*)(g + 4 * lane + 256 * j); bb[j] = *(const f32x4*)(bt + 4 * lane + 256 * j); }
    for (int m = gw; m < T_TOK; m += NGW) {
        float* xr = X + (size_t)m * DM + 4 * lane;
        f32x4 v[4]; float s = 0.f;
#pragma unroll
        for (int j = 0; j < 4; ++j) { v[j] = *(const f32x4*)(xr + 256 * j); s += (v[j].x + v[j].y) + (v[j].z + v[j].w); }
        const float mean = wave_sum(s) * (1.f / DM); float s2 = 0.f;
#pragma unroll
        for (int j = 0; j < 4; ++j) { v[j] = v[j] - mean; s2 += (v[j].x * v[j].x + v[j].y * v[j].y) + (v[j].z * v[j].z + v[j].w * v[j].w); }
        const float rstd = 1.f / sqrtf(wave_sum(s2) * (1.f / DM) + 1e-5f);
        bf16_t* ob = XB + (size_t)m * DM + 4 * lane;
#pragma unroll
        for (int j = 0; j < 4; ++j) { const f32x4 o = v[j] * rstd * gg[j] + bb[j]; *(f32x4*)(xr + 256 * j) = o;
            u32x2 w; w.x = pk2(o[0], o[1]); w.y = pk2(o[2], o[3]); *(u32x2*)(ob + 256 * j) = w; }
    }
}

__device__ __forceinline__ void lin_prep(PP P, int l, LAS unsigned char* lds) {
    int tid = threadIdx.x; asm volatile("" : "+v"(tid));
    const int lane = tid & 63, wid = tid >> 6, fr = lane & 15, fq = lane >> 4;
    LAS float* bL = (LAS float*)(lds);
    LAS float* seg = (LAS float*)(lds + 16640);
    LAS float* gaL = (LAS float*)(lds + 18688);
    LAS float* waL = (LAS float*)(lds + 22784);
    LAS bf16_t* kdT = (LAS bf16_t*)(lds + 26880);
    LAS bf16_t* vT = (LAS bf16_t*)(lds + 36096);
    bf16_t* PROJ1 = (bf16_t*)(P->ws + WS_PROJ); const float* GA = (const float*)(P->ws + WS_GA);
    bf16_t* KV = (bf16_t*)(P->ws + WS_KV); float* DEC = (float*)(P->ws + WS_DEC);
    const float* RC = (const float*)(P->ws + WS_RC); const float* RS = (const float*)(P->ws + WS_RS);
    for (int item = blockIdx.x; item < 4096; item += gridDim.x) {
        const int ty = item >> 11, b = (item >> 9) & 3, n = (item >> 2) & 127, h = item & 3;
        const size_t row0 = (size_t)b * SEQ + n * 64;
        const int qcol = ty ? 1536 + h * 64 : h * 64, kcol = qcol + 256, vcol = (ty ? 2048 : 512) + h * 128;
        {
            const int d = tid & 63, s = tid >> 6;
            if (ty == 0) {
                for (int idx = tid; idx < 1024; idx += 512) { gaL[idx] = GA[(row0 + (idx >> 4)) * 16 + (idx & 15)]; waL[idx] = P->in[2][(size_t)(l * 16 + (idx >> 6)) * 256 + h * 64 + (idx & 63)]; }
                __syncthreads();
                const float bias = P->in[3][l * 256 + h * 64 + d];
                float loc[8]; float run = 0.f;
#pragma unroll
                for (int k = 0; k < 8; ++k) { const int i = 8 * s + k; float z = bias;
#pragma unroll
                    for (int rr = 0; rr < 16; ++rr) z += gaL[i * 16 + rr] * waL[rr * 64 + d];
                    const float la = (fminf(z, 0.f) - log1pf(expf(-fabsf(z)))) * (1.f / 16.f); run += la; loc[k] = run; }
                seg[s * 64 + d] = run;
                __syncthreads();
                float pre = 0.f;
#pragma unroll
                for (int s2 = 0; s2 < 8; ++s2) pre += (s2 < s) ? seg[s2 * 64 + d] : 0.f;
#pragma unroll
                for (int k = 0; k < 8; ++k) bL[(8 * s + k) * 65 + d] = loc[k] + pre;
            } else {
                const float lg = log1pf(-exp2f(-5.f - (float)h));
#pragma unroll
                for (int k = 0; k < 8; ++k) { const int i = 8 * s + k; bL[i * 65 + d] = (float)(i + 1) * lg; }
            }
        }
        __syncthreads();
        {
            const int t2 = tid & 255, i = t2 >> 2, c = t2 & 3; const bool isk = tid >= 256;
            bf16_t* p = PROJ1 + (row0 + i) * LD1 + (isk ? kcol : qcol) + 8 * c;
            const u32x4 lo = *(const u32x4*)p, hi = *(const u32x4*)(p + 32);
            float xl[8], xh[8];
            xl[0] = bflo(lo.x); xl[1] = bfhi(lo.x); xl[2] = bflo(lo.y); xl[3] = bfhi(lo.y); xl[4] = bflo(lo.z); xl[5] = bfhi(lo.z); xl[6] = bflo(lo.w); xl[7] = bfhi(lo.w);
            xh[0] = bflo(hi.x); xh[1] = bfhi(hi.x); xh[2] = bflo(hi.y); xh[3] = bfhi(hi.y); xh[4] = bflo(hi.z); xh[5] = bfhi(hi.z); xh[6] = bflo(hi.w); xh[7] = bfhi(hi.w);
            if (ty == 1) {
                const float* rc = RC + (size_t)(n * 64 + i) * 32 + 8 * c; const float* rs = RS + (size_t)(n * 64 + i) * 32 + 8 * c;
#pragma unroll
                for (int j = 0; j < 8; ++j) { const float cs = rc[j], sn = rs[j], a = xl[j], bq = xh[j]; xl[j] = a * cs - bq * sn; xh[j] = bq * cs + a * sn; }
            }
            const float sc = isk ? (ty ? 0.125f : 1.f) : (ty ? 1.f : 0.125f);
#pragma unroll
            for (int j = 0; j < 8; ++j) {
                const float bl = bL[i * 65 + 8 * c + j], bh = bL[i * 65 + 32 + 8 * c + j];
                if (!isk) { xl[j] *= __expf(bl) * sc; xh[j] *= __expf(bh) * sc; }
                else {
                    const float ll = bL[63 * 65 + 8 * c + j], lh = bL[63 * 65 + 32 + 8 * c + j];
                    kdT[(8 * c + j) * 72 + i] = (bf16_t)f2bf(xl[j] * __expf(ll - bl) * sc);
                    kdT[(32 + 8 * c + j) * 72 + i] = (bf16_t)f2bf(xh[j] * __expf(lh - bh) * sc);
                    xl[j] *= __expf(-bl) * sc; xh[j] *= __expf(-bh) * sc;
                }
            }
            u32x4 wl, wh;
            wl.x = pk2(xl[0], xl[1]); wl.y = pk2(xl[2], xl[3]); wl.z = pk2(xl[4], xl[5]); wl.w = pk2(xl[6], xl[7]);
            wh.x = pk2(xh[0], xh[1]); wh.y = pk2(xh[2], xh[3]); wh.z = pk2(xh[4], xh[5]); wh.w = pk2(xh[6], xh[7]);
            *(u32x4*)p = wl; *(u32x4*)(p + 32) = wh;
        }
#pragma unroll
        for (int rep = 0; rep < 2; ++rep) {
            const int idx = tid + rep * 512, i = idx >> 4, c = idx & 15;
            const u32x4 v = *(const u32x4*)(PROJ1 + (row0 + i) * LD1 + vcol + 8 * c);
            LAS bf16_t* d0 = vT + (8 * c) * 72 + i;
            d0[0 * 72] = (bf16_t)(v.x & 0xffff); d0[1 * 72] = (bf16_t)(v.x >> 16); d0[2 * 72] = (bf16_t)(v.y & 0xffff); d0[3 * 72] = (bf16_t)(v.y >> 16);
            d0[4 * 72] = (bf16_t)(v.z & 0xffff); d0[5 * 72] = (bf16_t)(v.z >> 16); d0[6 * 72] = (bf16_t)(v.w & 0xffff); d0[7 * 72] = (bf16_t)(v.w >> 16);
        }
        __syncthreads();
        {
            const int mt = wid & 3;
#pragma unroll
            for (int k4 = 0; k4 < 4; ++k4) { const int nt = (wid >> 2) * 4 + k4; f32x4 acc = {0.f, 0.f, 0.f, 0.f};
#pragma unroll
                for (int ks = 0; ks < 2; ++ks) { const bf16x8 a = *(const LAS bf16x8*)(kdT + (16 * mt + fr) * 72 + 32 * ks + 8 * fq); const bf16x8 bb = *(const LAS bf16x8*)(vT + (16 * nt + fr) * 72 + 32 * ks + 8 * fq); acc = MFMA16(a, bb, acc); }
                u32x2 w; w.x = pk2(acc[0], acc[1]); w.y = pk2(acc[2], acc[3]);
                *(u32x2*)(KV + ((size_t)item * 128 + 16 * nt + fr) * 64 + 16 * mt + 4 * fq) = w; }
            if (tid < 64) DEC[item * 64 + tid] = __expf(bL[63 * 65 + tid]);
        }
        __syncthreads();
    }
}

__device__ __forceinline__ void lin_scan(PP P) {
    const bf16_t* KV = (const bf16_t*)(P->ws + WS_KV); bf16_t* KV2 = (bf16_t*)(P->ws + WS_ALT); const float* DEC = (const float*)(P->ws + WS_DEC);
    int tid = threadIdx.x; asm volatile("" : "+v"(tid));
    for (int g = blockIdx.x * 512 + tid; g < 131072; g += gridDim.x * 512) {
        const int tyb = g >> 14, h = (g >> 12) & 3, e = (g >> 5) & 127, dp = g & 31;
        float s0 = 0.f, s1 = 0.f;
        for (int n0 = 0; n0 < 128; n0 += 8) {
            unsigned kv[8]; f32x2 dc[8];
#pragma unroll
            for (int u = 0; u < 8; ++u) { const size_t idx = (size_t)((tyb * 128 + n0 + u) * 4 + h); kv[u] = *(const unsigned*)(KV + idx * 8192 + e * 64 + 2 * dp); dc[u] = *(const f32x2*)(DEC + idx * 64 + 2 * dp); }
#pragma unroll
            for (int u = 0; u < 8; ++u) { const size_t idx = (size_t)((tyb * 128 + n0 + u) * 4 + h);
                *(unsigned*)(KV2 + idx * 8192 + e * 64 + 2 * dp) = pk2(s0, s1);
                s0 = dc[u].x * s0 + bflo(kv[u]); s1 = dc[u].y * s1 + bfhi(kv[u]); }
        }
    }
}

__device__ __forceinline__ void lin_out(PP P, int l, LAS unsigned char* lds) {
    int tid = threadIdx.x; asm volatile("" : "+v"(tid));
    const int lane = tid & 63, wid = tid >> 6, fr = lane & 15, fq = lane >> 4;
    LAS bf16_t* qL = (LAS bf16_t*)(lds);
    LAS bf16_t* kL = (LAS bf16_t*)(lds + 9216);
    LAS bf16_t* vT = (LAS bf16_t*)(lds + 18432);
    LAS bf16_t* sT = (LAS bf16_t*)(lds + 36864);
    LAS bf16_t* aL = (LAS bf16_t*)(lds + 55296);
    LAS float* yL = (LAS float*)(lds + 64512);
    LAS float* stat = (LAS float*)(lds + 98304);
    const bf16_t* PROJ1 = (const bf16_t*)(P->ws + WS_PROJ); const bf16_t* KV = (const bf16_t*)(P->ws + WS_ALT); bf16_t* O = (bf16_t*)(P->ws + WS_O);
    for (int item = blockIdx.x; item < 4096; item += gridDim.x) {
        const int ty = item >> 11, b = (item >> 9) & 3, n = (item >> 2) & 127, h = item & 3;
        const size_t row0 = (size_t)b * SEQ + n * 64;
        const int qcol = ty ? 1536 + h * 64 : h * 64, kcol = qcol + 256, vcol = (ty ? 2048 : 512) + h * 128, gcol = (ty ? 2560 : 1024) + h * 128;
        { const int i = tid >> 3, c = tid & 7;
          *(LAS u32x4*)(qL + i * 72 + 8 * c) = *(const u32x4*)(PROJ1 + (row0 + i) * LD1 + qcol + 8 * c);
          *(LAS u32x4*)(kL + i * 72 + 8 * c) = *(const u32x4*)(PROJ1 + (row0 + i) * LD1 + kcol + 8 * c); }
#pragma unroll
        for (int rep = 0; rep < 2; ++rep) {
            const int idx = tid + rep * 512, i = idx >> 4, c = idx & 15;
            const u32x4 v = *(const u32x4*)(PROJ1 + (row0 + i) * LD1 + vcol + 8 * c);
            LAS bf16_t* d0 = vT + (8 * c) * 72 + i;
            d0[0 * 72] = (bf16_t)(v.x & 0xffff); d0[1 * 72] = (bf16_t)(v.x >> 16); d0[2 * 72] = (bf16_t)(v.y & 0xffff); d0[3 * 72] = (bf16_t)(v.y >> 16);
            d0[4 * 72] = (bf16_t)(v.z & 0xffff); d0[5 * 72] = (bf16_t)(v.z >> 16); d0[6 * 72] = (bf16_t)(v.w & 0xffff); d0[7 * 72] = (bf16_t)(v.w >> 16);
            const int e = idx >> 3, c2 = idx & 7;
            *(LAS u32x4*)(sT + e * 72 + 8 * c2) = *(const u32x4*)(KV + ((size_t)item * 128 + e) * 64 + 8 * c2);
        }
        __syncthreads();
        {
            const int it = wid >> 1;
#pragma unroll
            for (int k2 = 0; k2 < 2; ++k2) { const int jt = (wid & 1) * 2 + k2; f32x4 acc = {0.f, 0.f, 0.f, 0.f};
                if (jt <= it) {
#pragma unroll
                    for (int ks = 0; ks < 2; ++ks) { const bf16x8 a = *(const LAS bf16x8*)(qL + (16 * it + fr) * 72 + 32 * ks + 8 * fq); const bf16x8 bb = *(const LAS bf16x8*)(kL + (16 * jt + fr) * 72 + 32 * ks + 8 * fq); acc = MFMA16(a, bb, acc); }
                }
                const int j = 16 * jt + fr;
#pragma unroll
                for (int r = 0; r < 4; ++r) { const int i = 16 * it + 4 * fq + r; aL[i * 72 + j] = (bf16_t)f2bf(j <= i ? acc[r] : 0.f); } }
        }
        __syncthreads();
        const int mt = wid >> 1, hf = wid & 1;
        f32x4 o[4];
#pragma unroll
        for (int k4 = 0; k4 < 4; ++k4) { const int nt = hf * 4 + k4; f32x4 acc = {0.f, 0.f, 0.f, 0.f};
#pragma unroll
            for (int ks = 0; ks < 2; ++ks) { const bf16x8 a = *(const LAS bf16x8*)(aL + (16 * mt + fr) * 72 + 32 * ks + 8 * fq); const bf16x8 bb = *(const LAS bf16x8*)(vT + (16 * nt + fr) * 72 + 32 * ks + 8 * fq); acc = MFMA16(a, bb, acc); }
#pragma unroll
            for (int ks = 0; ks < 2; ++ks) { const bf16x8 a = *(const LAS bf16x8*)(qL + (16 * mt + fr) * 72 + 32 * ks + 8 * fq); const bf16x8 bb = *(const LAS bf16x8*)(sT + (16 * nt + fr) * 72 + 32 * ks + 8 * fq); acc = MFMA16(a, bb, acc); }
            o[k4] = acc; }
#pragma unroll
        for (int r = 0; r < 4; ++r) { float s1 = 0.f, s2 = 0.f;
#pragma unroll
            for (int k4 = 0; k4 < 4; ++k4) { s1 += o[k4][r]; s2 += o[k4][r] * o[k4][r]; }
            s1 += __shfl_xor(s1, 1); s2 += __shfl_xor(s2, 1); s1 += __shfl_xor(s1, 2); s2 += __shfl_xor(s2, 2);
            s1 += __shfl_xor(s1, 4); s2 += __shfl_xor(s2, 4); s1 += __shfl_xor(s1, 8); s2 += __shfl_xor(s2, 8);
            if (fr == 0) { const int i = 16 * mt + 4 * fq + r; stat[(i * 2 + hf) * 2] = s1; stat[(i * 2 + hf) * 2 + 1] = s2; } }
        __syncthreads();
#pragma unroll
        for (int r = 0; r < 4; ++r) { const int i = 16 * mt + 4 * fq + r;
            const float s1 = stat[i * 4] + stat[i * 4 + 2], s2 = stat[i * 4 + 1] + stat[i * 4 + 3];
            float mu, rs;
            if (ty == 0) { mu = 0.f; rs = 1.f / sqrtf(s2 * (1.f / 128.f) + 1e-6f); }
            else { mu = s1 * (1.f / 128.f); const float var = fmaxf(s2 * (1.f / 128.f) - mu * mu, 0.f); rs = 1.f / sqrtf(var + 1e-5f); }
#pragma unroll
            for (int k4 = 0; k4 < 4; ++k4) yL[i * 132 + 16 * (hf * 4 + k4) + fr] = (o[k4][r] - mu) * rs; }
        __syncthreads();
        const float* gain = (ty ? P->in[5] : P->in[4]) + l * 512 + h * 128;
#pragma unroll
        for (int rep = 0; rep < 2; ++rep) {
            const int idx = tid + rep * 512, i = idx >> 4, c = idx & 15;
            const u32x4 gw = *(const u32x4*)(PROJ1 + (row0 + i) * LD1 + gcol + 8 * c);
            const f32x4 g0 = *(const f32x4*)(gain + 8 * c), g1 = *(const f32x4*)(gain + 8 * c + 4);
            const f32x4 y0 = *(const LAS f32x4*)(yL + i * 132 + 8 * c), y1 = *(const LAS f32x4*)(yL + i * 132 + 8 * c + 4);
            u32x4 w;
            w.x = pk2(y0[0] * g0[0] * siluf_(bflo(gw.x)), y0[1] * g0[1] * siluf_(bfhi(gw.x)));
            w.y = pk2(y0[2] * g0[2] * siluf_(bflo(gw.y)), y0[3] * g0[3] * siluf_(bfhi(gw.y)));
            w.z = pk2(y1[0] * g1[0] * siluf_(bflo(gw.z)), y1[1] * g1[1] * siluf_(bfhi(gw.z)));
            w.w = pk2(y1[2] * g1[2] * siluf_(bflo(gw.w)), y1[3] * g1[3] * siluf_(bfhi(gw.w)));
            *(u32x4*)(O + (row0 + i) * LDO + ty * 512 + h * 128 + 8 * c) = w;
        }
        __syncthreads();
    }
}


__device__ __forceinline__ void lin_naive_rec(PP P, int l) {
    int tid = threadIdx.x; asm volatile("" : "+v"(tid));
    const int d = tid & 63, w = tid >> 6;
    const bf16_t* PROJ1 = (const bf16_t*)(P->ws + WS_PROJ); const float* GA = (const float*)(P->ws + WS_GA);
    const float* RC = (const float*)(P->ws + WS_RC); const float* RS = (const float*)(P->ws + WS_RS);
    for (int wgi = blockIdx.x; wgi < 256; wgi += gridDim.x) {
        const int seq = wgi >> 3, ty = seq >> 4, b = (seq >> 2) & 3, h = seq & 3, e = 16 * (wgi & 7) + 2 * w;
        float* OF = (float*)(P->ws + (ty ? WS_ALT : WS_KV));
        const int qcol = ty ? 1536 + h * 64 : h * 64, kcol = qcol + 256, vcol = (ty ? 2048 : 512) + h * 128;
        float wa[16];
#pragma unroll
        for (int rr = 0; rr < 16; ++rr) wa[rr] = P->in[2][(size_t)(l * 16 + rr) * 256 + h * 64 + d];
        const float bias = P->in[3][l * 256 + h * 64 + d];
        const float lg = log1pf(-exp2f(-5.f - (float)h));
        float s0 = 0.f, s1 = 0.f;
        for (int t = 0; t < SEQ; ++t) {
            const size_t row = (size_t)b * SEQ + t;
            float q = bflo((unsigned)PROJ1[row * LD1 + qcol + d]), k = bflo((unsigned)PROJ1[row * LD1 + kcol + d]);
            float la;
            if (ty) {
                const float qo = __shfl_xor(q, 32), ko = __shfl_xor(k, 32);
                const float cs = RC[t * 32 + (d & 31)], sn = RS[t * 32 + (d & 31)];
                if (d < 32) { q = q * cs - qo * sn; k = k * cs - ko * sn; } else { q = q * cs + qo * sn; k = k * cs + ko * sn; }
                k *= 0.125f; la = lg;
            } else {
                float z = bias;
#pragma unroll
                for (int rr = 0; rr < 16; ++rr) z += GA[row * 16 + rr] * wa[rr];
                la = (fminf(z, 0.f) - log1pf(expf(-fabsf(z)))) * (1.f / 16.f); q *= 0.125f;
            }
            const float a = expf(la);
            const unsigned vv = *(const unsigned*)(PROJ1 + row * LD1 + vcol + e);
            s0 = a * s0 + k * bflo(vv); s1 = a * s1 + k * bfhi(vv);
            const float o0 = wave_sum(q * s0), o1 = wave_sum(q * s1);
            if (d == 0) { f32x2 o; o.x = o0; o.y = o1; *(f32x2*)(OF + row * 512 + h * 128 + e) = o; }
        }
    }
}
__device__ __forceinline__ void lin_naive_norm(PP P, int l) {
    int tid = threadIdx.x; asm volatile("" : "+v"(tid));
    const int lane = tid & 63, wave = tid >> 6;
    const bf16_t* PROJ1 = (const bf16_t*)(P->ws + WS_PROJ); bf16_t* O = (bf16_t*)(P->ws + WS_O);
    const int gw = blockIdx.x * 8 + wave, NGW = gridDim.x * 8;
    for (int it = gw; it < T_TOK * 8; it += NGW) {
        const int row = it >> 3, ty = (it >> 2) & 1, h = it & 3;
        const float* OF = (const float*)(P->ws + (ty ? WS_ALT : WS_KV));
        const f32x2 o = *(const f32x2*)(OF + (size_t)row * 512 + h * 128 + 2 * lane);
        const float s1 = wave_sum(o.x + o.y), s2 = wave_sum(o.x * o.x + o.y * o.y);
        float mu, rs;
        if (ty == 0) { mu = 0.f; rs = 1.f / sqrtf(s2 * (1.f / 128.f) + 1e-6f); }
        else { mu = s1 * (1.f / 128.f); const float var = fmaxf(s2 * (1.f / 128.f) - mu * mu, 0.f); rs = 1.f / sqrtf(var + 1e-5f); }
        const float* gain = (ty ? P->in[5] : P->in[4]) + l * 512 + h * 128 + 2 * lane;
        const unsigned gw2 = *(const unsigned*)(PROJ1 + (size_t)row * LD1 + (ty ? 2560 : 1024) + h * 128 + 2 * lane);
        *(unsigned*)(O + (size_t)row * LDO + ty * 512 + h * 128 + 2 * lane) = pk2((o.x - mu) * rs * gain[0] * siluf_(bflo(gw2)), (o.y - mu) * rs * gain[1] * siluf_(bfhi(gw2)));
    }
}

__device__ __forceinline__ void load_qk_tile(const bf16_t* src  , size_t rowstride, int pos0, int posstride, float scale, LAS bf16_t* dst, const float* DC, const float* DS, int tid) {
    const int row = tid >> 2, cq = tid & 3;
    const bf16_t* p = src + (size_t)row * rowstride + 32 * cq;
    const u32x4 v0 = *(const u32x4*)p, v1 = *(const u32x4*)(p + 8), v2 = *(const u32x4*)(p + 16), v3 = *(const u32x4*)(p + 24);
    float x[32];
    x[0] = bflo(v0.x); x[1] = bfhi(v0.x); x[2] = bflo(v0.y); x[3] = bfhi(v0.y); x[4] = bflo(v0.z); x[5] = bfhi(v0.z); x[6] = bflo(v0.w); x[7] = bfhi(v0.w);
    x[8] = bflo(v1.x); x[9] = bfhi(v1.x); x[10] = bflo(v1.y); x[11] = bfhi(v1.y); x[12] = bflo(v1.z); x[13] = bfhi(v1.z); x[14] = bflo(v1.w); x[15] = bfhi(v1.w);
    x[16] = bflo(v2.x); x[17] = bfhi(v2.x); x[18] = bflo(v2.y); x[19] = bfhi(v2.y); x[20] = bflo(v2.z); x[21] = bfhi(v2.z); x[22] = bflo(v2.w); x[23] = bfhi(v2.w);
    x[24] = bflo(v3.x); x[25] = bfhi(v3.x); x[26] = bflo(v3.y); x[27] = bfhi(v3.y); x[28] = bflo(v3.z); x[29] = bfhi(v3.z); x[30] = bflo(v3.w); x[31] = bfhi(v3.w);
    if (cq == 0) {
        const int pos = pos0 + row * posstride;
        const float* dc = DC + (size_t)pos * 16; const float* ds = DS + (size_t)pos * 16;
#pragma unroll
        for (int j4 = 0; j4 < 4; ++j4) { const f32x4 c4 = *(const f32x4*)(dc + 4 * j4), s4 = *(const f32x4*)(ds + 4 * j4);
#pragma unroll
            for (int jj = 0; jj < 4; ++jj) { const int j = 4 * j4 + jj; const float a = x[j], bq = x[16 + j]; x[j] = a * c4[jj] - bq * s4[jj]; x[16 + j] = bq * c4[jj] + a * s4[jj]; } }
    }
    LAS bf16_t* d = dst + row * 136 + 32 * cq;
#pragma unroll
    for (int k = 0; k < 4; ++k) { u32x4 w; w.x = pk2(x[8 * k] * scale, x[8 * k + 1] * scale); w.y = pk2(x[8 * k + 2] * scale, x[8 * k + 3] * scale); w.z = pk2(x[8 * k + 4] * scale, x[8 * k + 5] * scale); w.w = pk2(x[8 * k + 6] * scale, x[8 * k + 7] * scale);
        *(LAS u32x4*)(d + 8 * k) = w; }
}

__device__ __forceinline__ void dil_attn(PP P, LAS unsigned char* lds) {
    int tid = threadIdx.x; asm volatile("" : "+v"(tid));
    const int lane = tid & 63, wid = tid >> 6, fr = lane & 15, fq = lane >> 4;
    LAS bf16_t* QL = (LAS bf16_t*)(lds);
    LAS bf16_t* KL = (LAS bf16_t*)(lds + 34816);
    LAS bf16_t* VT = (LAS bf16_t*)(lds + 69632);
    bf16_t* PROJ2 = (bf16_t*)(P->ws + WS_PROJ); float* LSE = (float*)(P->ws + WS_LSE); bf16_t* OG = (bf16_t*)(P->ws + WS_ALT);
    const float* DC = (const float*)(P->ws + WS_DC); const float* DS = (const float*)(P->ws + WS_DS);
    const float QSCALE = 0.08838834764831845f * 1.4426950408889634f;
    for (int item = blockIdx.x; item < 3072; item += gridDim.x) {
        const int g = item >> 10, rem = item & 1023, b = rem >> 8, h = (rem >> 6) & 3, idx64 = rem & 63;
        const int dsh = 2 * g, tsh = 6 - dsh, c = idx64 >> tsh, mt = idx64 & ((1 << tsh) - 1), dil = 1 << dsh;
        const int qcol = g * 512 + h * 128, kcol = 1536 + qcol, vcol = 3072 + qcol;
        const size_t rstride = (size_t)LD2 << dsh;
        bf16_t* base = PROJ2 + ((size_t)b * SEQ + c) * LD2;
        __syncthreads();
        load_qk_tile(base + (size_t)(mt * 128) * rstride + qcol, rstride, (mt * 128) * dil + c, dil, QSCALE, QL, DC, DS, tid);
        __syncthreads();
        bf16x8 qf[4];
#pragma unroll
        for (int ks = 0; ks < 4; ++ks) qf[ks] = *(const LAS bf16x8*)(QL + (16 * wid + fr) * 136 + 32 * ks + 8 * fq);
        float m_run = -INFINITY, l_run = 0.f;
        f32x4 o[8];
#pragma unroll
        for (int et = 0; et < 8; ++et) o[et] = (f32x4){0.f, 0.f, 0.f, 0.f};
        for (int kt = (mt > 0 ? 0 : 1); kt < 2; ++kt) {
            const int m0k = mt * 128 - 128 + kt * 128;
            __syncthreads();
            load_qk_tile(base + (size_t)m0k * rstride + kcol, rstride, m0k * dil + c, dil, 1.f, KL, DC, DS, tid);
#pragma unroll
            for (int rep = 0; rep < 2; ++rep) {
                const int idx = tid + rep * 512, rp = idx >> 4, cc = idx & 15;
                const bf16_t* pv = base + (size_t)(m0k + 2 * rp) * rstride + vcol + 8 * cc;
                const u32x4 a = *(const u32x4*)pv, bb = *(const u32x4*)(pv + rstride);
                LAS unsigned* d0 = (LAS unsigned*)(VT + (8 * cc) * 136 + 2 * rp);
                d0[0 * 68] = (a.x & 0xffffu) | (bb.x << 16); d0[1 * 68] = (a.x >> 16) | (bb.x & 0xffff0000u);
                d0[2 * 68] = (a.y & 0xffffu) | (bb.y << 16); d0[3 * 68] = (a.y >> 16) | (bb.y & 0xffff0000u);
                d0[4 * 68] = (a.z & 0xffffu) | (bb.z << 16); d0[5 * 68] = (a.z >> 16) | (bb.z & 0xffff0000u);
                d0[6 * 68] = (a.w & 0xffffu) | (bb.w << 16); d0[7 * 68] = (a.w >> 16) | (bb.w & 0xffff0000u);
            }
            __syncthreads();
            f32x4 s[8];
#pragma unroll
            for (int jt = 0; jt < 8; ++jt) { f32x4 acc = {0.f, 0.f, 0.f, 0.f};
#pragma unroll
                for (int ks = 0; ks < 4; ++ks) { const bf16x8 a = *(const LAS bf16x8*)(KL + (16 * jt + fr) * 136 + 32 * ks + 8 * fq); acc = MFMA16(a, qf[ks], acc); }
                s[jt] = acc; }
            const int iq = 16 * wid + fr;
            float mx = -INFINITY;
#pragma unroll
            for (int jt = 0; jt < 8; ++jt)
#pragma unroll
                for (int r = 0; r < 4; ++r) { const int jk = 16 * jt + 4 * fq + r; const bool ok = kt ? (jk <= iq) : (jk >= iq); s[jt][r] = ok ? s[jt][r] : -INFINITY; mx = fmaxf(mx, s[jt][r]); }
            mx = fmaxf(mx, __shfl_xor(mx, 16)); mx = fmaxf(mx, __shfl_xor(mx, 32));
            const float m_new = fmaxf(m_run, mx);
            const float alpha = __builtin_amdgcn_exp2f(m_run - m_new);
            float ls = 0.f;
#pragma unroll
            for (int jt = 0; jt < 8; ++jt)
#pragma unroll
                for (int r = 0; r < 4; ++r) { s[jt][r] = __builtin_amdgcn_exp2f(s[jt][r] - m_new); ls += s[jt][r]; }
            l_run = l_run * alpha + ls; m_run = m_new;
            float al[4];
#pragma unroll
            for (int r = 0; r < 4; ++r) al[r] = __shfl(alpha, 4 * fq + r);
#pragma unroll
            for (int et = 0; et < 8; ++et)
#pragma unroll
                for (int r = 0; r < 4; ++r) o[et][r] *= al[r];
#pragma unroll
            for (int ss = 0; ss < 4; ++ss) {
                u32x4 pw; pw.x = pk2(s[2 * ss][0], s[2 * ss][1]); pw.y = pk2(s[2 * ss][2], s[2 * ss][3]); pw.z = pk2(s[2 * ss + 1][0], s[2 * ss + 1][1]); pw.w = pk2(s[2 * ss + 1][2], s[2 * ss + 1][3]);
                const bf16x8 pa = __builtin_bit_cast(bf16x8, pw);
#pragma unroll
                for (int et = 0; et < 8; ++et) {
                    const u32x2 lo = *(const LAS u32x2*)(VT + (16 * et + fr) * 136 + 32 * ss + 4 * fq);
                    const u32x2 hi = *(const LAS u32x2*)(VT + (16 * et + fr) * 136 + 32 * ss + 16 + 4 * fq);
                    u32x4 vw; vw.x = lo.x; vw.y = lo.y; vw.z = hi.x; vw.w = hi.y;
                    o[et] = MFMA16(pa, __builtin_bit_cast(bf16x8, vw), o[et]);
                }
            }
        }
        float l_tot = l_run; l_tot += __shfl_xor(l_tot, 16); l_tot += __shfl_xor(l_tot, 32);
        const float inv_l = 1.f / l_tot;
        float il[4];
#pragma unroll
        for (int r = 0; r < 4; ++r) il[r] = __shfl(inv_l, 4 * fq + r);
#pragma unroll
        for (int et = 0; et < 8; ++et)
#pragma unroll
            for (int r = 0; r < 4; ++r) QL[(16 * wid + 4 * fq + r) * 136 + 16 * et + fr] = (bf16_t)f2bf(o[et][r] * il[r]);
        if (fq == 0) { const int m = mt * 128 + 16 * wid + fr; LSE[((size_t)b * SEQ + (size_t)m * dil + c) * 12 + g * 4 + h] = (m_run + __log2f(l_tot)) * 0.6931471805599453f; }
        asm volatile("s_waitcnt lgkmcnt(0)" ::: "memory");
#pragma unroll
        for (int k = 0; k < 4; ++k) { const int idx = lane + 64 * k, rr = idx >> 4, cc = idx & 15;
            const u32x4 v = *(const LAS u32x4*)(QL + (16 * wid + rr) * 136 + 8 * cc);
            *(u32x4*)(OG + ((size_t)b * SEQ + c + (size_t)(mt * 128 + 16 * wid + rr) * dil) * LDO + qcol + 8 * cc) = v; }
    }
    __syncthreads();
}


__device__ __forceinline__ void dil_attn_naive(PP P) {
    int tid = threadIdx.x; asm volatile("" : "+v"(tid));
    const int lane = tid & 63, wave = tid >> 6;
    const bf16_t* PROJ2 = (const bf16_t*)(P->ws + WS_PROJ); float* LSE = (float*)(P->ws + WS_LSE); bf16_t* OG = (bf16_t*)(P->ws + WS_ALT);
    const float* DC = (const float*)(P->ws + WS_DC); const float* DS = (const float*)(P->ws + WS_DS);
    const int gw = blockIdx.x * 8 + wave, NGW = gridDim.x * 8;
    for (int it = gw; it < T_TOK * 12; it += NGW) {
        const int row = it / 12, gh = it - row * 12, g = gh >> 2, h = gh & 3;
        const int b = row >> 13, t = row & 8191, dil = 1 << (2 * g);
        const bf16_t* qp = PROJ2 + (size_t)row * LD2 + g * 512 + h * 128;
        float sc[3];
#pragma unroll
        for (int kk = 0; kk < 3; ++kk) {
            const int j = lane + 64 * kk; const int tk = t - dil * j; const bool valid = (j <= 128) && (tk >= 0);
            float dot = 0.f;
            if (valid) {
                const bf16_t* kp = PROJ2 + ((size_t)b * SEQ + tk) * LD2 + 1536 + g * 512 + h * 128;
                for (int i = 0; i < 16; ++i) {
                    const float q1 = bflo((unsigned)qp[i]), q2 = bflo((unsigned)qp[16 + i]), k1 = bflo((unsigned)kp[i]), k2 = bflo((unsigned)kp[16 + i]);
                    const float cq = DC[t * 16 + i], sq = DS[t * 16 + i], ck = DC[tk * 16 + i], sk = DS[tk * 16 + i];
                    dot += (q1 * cq - q2 * sq) * (k1 * ck - k2 * sk) + (q2 * cq + q1 * sq) * (k2 * ck + k1 * sk);
                }
                for (int d = 32; d < 128; ++d) dot += bflo((unsigned)qp[d]) * bflo((unsigned)kp[d]);
            }
            sc[kk] = valid ? dot * 0.08838834764831845f : -INFINITY;
        }
        float m = fmaxf(sc[0], fmaxf(sc[1], sc[2]));
#pragma unroll
        for (int o = 1; o < 64; o <<= 1) m = fmaxf(m, __shfl_xor(m, o));
        float p0 = __expf(sc[0] - m), p1 = __expf(sc[1] - m), p2 = __expf(sc[2] - m);
        float l = wave_sum(p0 + p1 + p2);
        float o0 = 0.f, o1 = 0.f;
        for (int j = 0; j <= 128; ++j) {
            const float pj = (j < 64) ? __shfl(p0, j) : (j < 128) ? __shfl(p1, j - 64) : __shfl(p2, 0);
            const int tk = t - dil * j;
            if (tk >= 0) { const unsigned v = *(const unsigned*)(PROJ2 + ((size_t)b * SEQ + tk) * LD2 + 3072 + g * 512 + h * 128 + 2 * lane); o0 += pj * bflo(v); o1 += pj * bfhi(v); }
        }
        const float il = 1.f / l;
        *(unsigned*)(OG + (size_t)row * LDO + g * 512 + h * 128 + 2 * lane) = pk2(o0 * il, o1 * il);
        if (lane == 0) LSE[(size_t)row * 12 + gh] = m + __logf(l);
    }
}

__device__ __forceinline__ void dil_merge(PP P) {
    const bf16_t* PROJ2 = (const bf16_t*)(P->ws + WS_ALT); const float* LSE = (const float*)(P->ws + WS_LSE); bf16_t* O = (bf16_t*)(P->ws + WS_O);
    const size_t NT = (size_t)gridDim.x * 512;
    int tid = threadIdx.x; asm volatile("" : "+v"(tid));
    for (size_t i = (size_t)blockIdx.x * 512 + tid; i < (size_t)T_TOK * 64; i += NT) {
        const size_t row = i >> 6; const int h = (int)(i >> 4) & 3, c = (int)i & 15;
        const float l0 = LSE[row * 12 + h], l1 = LSE[row * 12 + 4 + h], l2 = LSE[row * 12 + 8 + h];
        const float mx = fmaxf(l0, fmaxf(l1, l2));
        float w0 = __expf(l0 - mx), w1 = __expf(l1 - mx), w2 = __expf(l2 - mx); const float inv = 1.f / (w0 + w1 + w2); w0 *= inv; w1 *= inv; w2 *= inv;
        const bf16_t* p = PROJ2 + row * LDO + h * 128 + 8 * c;
        const u32x4 a = *(const u32x4*)p, b = *(const u32x4*)(p + 512), d = *(const u32x4*)(p + 1024);
        u32x4 w;
        w.x = pk2(w0 * bflo(a.x) + w1 * bflo(b.x) + w2 * bflo(d.x), w0 * bfhi(a.x) + w1 * bfhi(b.x) + w2 * bfhi(d.x));
        w.y = pk2(w0 * bflo(a.y) + w1 * bflo(b.y) + w2 * bflo(d.y), w0 * bfhi(a.y) + w1 * bfhi(b.y) + w2 * bfhi(d.y));
        w.z = pk2(w0 * bflo(a.z) + w1 * bflo(b.z) + w2 * bflo(d.z), w0 * bfhi(a.z) + w1 * bfhi(b.z) + w2 * bfhi(d.z));
        w.w = pk2(w0 * bflo(a.w) + w1 * bflo(b.w) + w2 * bflo(d.w), w0 * bfhi(a.w) + w1 * bfhi(b.w) + w2 * bfhi(d.w));
        *(u32x4*)(O + row * LDO + 1024 + h * 128 + 8 * c) = w;
    }
}


__global__ void __launch_bounds__(512) fwd_kernel(Params Pval) {
    extern __shared__ __attribute__((aligned(16))) unsigned char lds_raw[];
    LAS unsigned char* lds = (LAS unsigned char*)lds_raw;
    const int tid = threadIdx.x;
    for (int u = tid; u < (LDS_BYTES - LDSCTL_OFF) / 4; u += 512) ((LAS unsigned*)(lds + LDSCTL_OFF))[u] = 0u;
    __syncthreads();
    { PP P = get_pp(); (void)xcd_barrier_post((unsigned*)(P->ws + WS_CTL) + 4096, (volatile LAS unsigned*)(lds + MISC_OFF) + 8); }
#define GRID_BAR() do { PP q_ = get_pp(); XcdBarrier b_; b_.bar = (unsigned*)(q_->ws + WS_CTL) + 4096; b_.x = xb_xcc_id(); b_.st = (volatile LAS unsigned*)(lds + MISC_OFF) + 8; xcd_barrier(b_); } while (0)
#define G ((int)gridDim.x)
#define cid ((int)blockIdx.x)
#define XB ((bf16_t*)(P->ws + WS_XB))
#define Obuf ((bf16_t*)(P->ws + WS_O))
#define WIN ((bf16_t*)(P->ws + WS_WIN))
#define WB ((bf16_t*)(P->ws + WS_WB))
#define WOUT ((bf16_t*)(P->ws + WS_WOUT))
#define WGU ((bf16_t*)(P->ws + WS_WGU))
#define WD ((bf16_t*)(P->ws + WS_WD))
#define PROJ ((bf16_t*)(P->ws + WS_PROJ))
#define MERGED ((bf16_t*)(P->ws + WS_MERGED))

#ifndef PHMASK
#define PHMASK 0xffff
#endif
#define PH(k) ((PHMASK >> (k)) & 1)
    for (int l = 0; l < NLAYER; ++l) {
        if (PH(0)) { PP P = get_pp(); convert_weights(P, l, lds); }
        if (l == 0) { if (PH(0)) { PP P = get_pp(); prep0(P); } cg::this_grid().sync(); }
        GRID_BAR();
        if (PH(1)) { PP P = get_pp(); pg8::Gemm g{XB, WIN, DM, DM, DM, 0, 0}; pg8::Order S; S.init(T_TOK, 3328, G, cid, 1);
          pg8::EpiBf16<1> E{PROJ, LD1, nullptr, (float*)(P->ws + WS_GA), 12};
          pg8::gemm_phase(lds, g, S, E); }
        GRID_BAR();
#ifdef NAIVE_LIN
        { PP P = get_pp(); lin_naive_rec(P, l); }
        GRID_BAR();
        { PP P = get_pp(); lin_naive_norm(P, l); }
        GRID_BAR();
#else
        if (PH(2)) { PP P = get_pp(); lin_prep(P, l, lds); }
        GRID_BAR();
        if (PH(3)) { PP P = get_pp(); lin_scan(P); }
        GRID_BAR();
        if (PH(4)) { PP P = get_pp(); lin_out(P, l, lds); }
        GRID_BAR();
#endif
        if (PH(5)) { PP P = get_pp(); pg8::Gemm g{XB, WIN + (size_t)3328 * DM, DM, DM, DM, 0, 0}; pg8::Order S; S.init(T_TOK, 4608, G, cid, 1);
          pg8::EpiBf16<0> E{PROJ, LD2, nullptr, nullptr, -1};
          pg8::gemm_phase(lds, g, S, E); }
        GRID_BAR();
#ifdef NAIVE_DIL
        if (PH(6)) { PP P = get_pp(); dil_attn_naive(P); }
#else
        if (PH(6)) { PP P = get_pp(); dil_attn(P, lds); }
#endif
        GRID_BAR();
        if (PH(7)) { PP P = get_pp(); dil_merge(P); }
        GRID_BAR();
        if (PH(8)) { PP P = get_pp(); pg8::Gemm g{XB, WIN + (size_t)7936 * DM, DM, DM, DM, 0, 0}; pg8::Order S; S.init(T_TOK, 3072, G, cid, 1);
          pg8::EpiBf16<2> E{PROJ, LDG, P->in[7] + (size_t)l * 3072, nullptr, -1};
          pg8::gemm_phase(lds, g, S, E); }
        GRID_BAR();
        if (PH(9)) { PP P = get_pp(); pg8::Gemm g{Obuf, WB, LDO, 512, 512, 512, (long)DM * 512}; pg8::Order S; S.init(T_TOK, DM, G, cid, 3);
          pg8::EpiBranch E{PROJ, (float*)(P->ws + WS_KV) + (size_t)cid * 65536, MERGED};
          pg8::gemm_phase(lds, g, S, E); }
        GRID_BAR();
        if (PH(10)) { PP P = get_pp(); pg8::Gemm g{MERGED, WOUT, DM, DM, DM, 0, 0}; pg8::Order S; S.init(T_TOK, DM, G, cid, 1);
          pg8::EpiResid E{l == 0 ? P->in[0] : P->out, P->out};
          pg8::gemm_phase(lds, g, S, E); }
        GRID_BAR();
        if (PH(11)) { PP P = get_pp(); ln_pass(P->out, XB, P->in[9] + l * DM, P->in[10] + l * DM); }
        GRID_BAR();
        if (PH(12)) { PP P = get_pp(); pg8::Gemm g{XB, WGU, DM, DM, DM, 0, 0}; pg8::Order S; S.init(T_TOK, 2 * DFF, G, cid, 1);
          pg8::EpiSwiglu E{PROJ};
          pg8::gemm_phase(lds, g, S, E); }
        GRID_BAR();
        if (PH(13)) { PP P = get_pp(); pg8::Gemm g{PROJ, WD, DFF, DFF, DFF, 0, 0}; pg8::Order S; S.init(T_TOK, DM, G, cid, 1);
          pg8::EpiResid E{P->out, P->out};
          pg8::gemm_phase(lds, g, S, E); }
        GRID_BAR();
        if (PH(14)) { PP P = get_pp(); ln_pass(P->out, XB, P->in[14] + l * DM, P->in[15] + l * DM); }
        GRID_BAR();
    }
}

extern "C" void kernel_launch(void* const* d_in, const int* in_sizes, int n_in, void* d_out, int out_size, void* d_ws, size_t ws_size, hipStream_t stream) {
    static int grid = 0;
    if (grid == 0) {
        if (n_in != 16 || out_size != T_TOK * DM || ws_size < WS_END) { fprintf(stderr, "kernel_launch: unexpected shapes (n_in %d out %d ws %zu)\n", n_in, out_size, ws_size); grid = -1; return; }
        int dev = 0, cus = 0, per_cu = 0;
        hipGetDevice(&dev);
        hipDeviceGetAttribute(&cus, hipDeviceAttributeMultiprocessorCount, dev);
        hipFuncSetAttribute((const void*)fwd_kernel, hipFuncAttributeMaxDynamicSharedMemorySize, LDS_BYTES);
        hipOccupancyMaxActiveBlocksPerMultiprocessor(&per_cu, (const void*)fwd_kernel, 512, LDS_BYTES);
        if (per_cu < 1) per_cu = 1;
        (void)hipGetLastError();
        grid = cus * 1;
    }
    if (grid < 0) return;
    hipMemsetAsync((char*)d_ws + WS_CTL, 0, CTL_ZERO_BYTES, stream);
    Params p{};
    for (int i = 0; i < 16; ++i) p.in[i] = (const float*)d_in[i];
    p.out = (float*)d_out; p.ws = (unsigned char*)d_ws;
    void* args[] = {&p};
    hipError_t e = hipLaunchCooperativeKernel((const void*)fwd_kernel, dim3(grid), dim3(512), args, LDS_BYTES, stream);
    if (e != hipSuccess) fprintf(stderr, "cooperative launch failed: %s (grid %d)\n", hipGetErrorString(e), grid);
}
```
